# Optimizing an MI355X kernel written in HIP

```python
import math
import jax, jax.numpy as jnp
from jax import lax
import numpy as np

D_MODEL = 1024
BATCH = 4
SEQ = 4096
DEPTH = 1

MEM_LEN = 256
HEAD_DIM = 64
CONV_CH = D_MODEL // 2
CONV_WIDTH = 31
ATT_HEADS = (D_MODEL // 2) // HEAD_DIM
KV_HEADS = 2
GQA_GROUP = ATT_HEADS // KV_HEADS
WINDOW = 128
BLOCK = 128
REL_BUCKETS = 32
REL_MAX_DIST = 128
Q_COLS = ATT_HEADS * HEAD_DIM
KV_COLS = KV_HEADS * HEAD_DIM
MIX_WIDTH = CONV_CH + Q_COLS
IN_COLS = 2 * CONV_CH + Q_COLS + 2 * KV_COLS
X_HEADS = 4
X_HEAD_DIM = D_MODEL // X_HEADS
N_EXPERTS = 64
TOP_K = 8
N_GROUPS = 8
TOPK_GROUPS = 4
EXPERT_FF = D_MODEL // 4
SHARED_FF = EXPERT_FF
ROUTED_SCALE = 2.5
EXPERT_BLOCK = 256
ALPHA = (2 * DEPTH) ** 0.25
BETA = (8 * DEPTH) ** -0.25
LN_EPS = 1e-5
NEG_INF = -1e30

kernel_name = 'hymba_conformer_swa_sink_moe_deepnorm'


def layer_norm(x, g, b):
    xf = x.astype(jnp.float32)
    mu = jnp.mean(xf, axis=-1, keepdims=True)
    var = jnp.mean(jnp.square(xf - mu), axis=-1, keepdims=True)
    return ((xf - mu) * lax.rsqrt(var + LN_EPS) * g + b).astype(x.dtype)


def t5_bucket(dist):
    n = jnp.maximum(dist, 0)
    exact = REL_BUCKETS // 2
    large = exact + (jnp.log(jnp.maximum(n, 1).astype(jnp.float32) / exact)
                     / math.log(REL_MAX_DIST / exact) * (REL_BUCKETS - exact)).astype(jnp.int32)
    large = jnp.minimum(large, REL_BUCKETS - 1)
    return jnp.where(n < exact, n, large)


def band_bias_and_mask(rel_bias, seq):
    n_blocks = seq // BLOCK
    qi = jnp.arange(BLOCK)[:, None]
    kj = jnp.arange(2 * BLOCK)[None, :]
    dist = qi + BLOCK - kj
    bias = rel_bias[t5_bucket(dist)].astype(jnp.float32)
    bias = jnp.transpose(bias, (2, 0, 1)).reshape(KV_HEADS, GQA_GROUP, BLOCK, 2 * BLOCK)
    key_pos = jnp.arange(n_blocks)[:, None, None] * BLOCK - BLOCK + kj[None]
    mask = (dist >= 0) & (dist < WINDOW) & (key_pos >= 0)
    return bias, mask


def sliding_window_sink_attention(q, k, v, sinks, bias, mask):
    b, s = q.shape[:2]
    nb = s // BLOCK
    qb = q.reshape(b, nb, BLOCK, KV_HEADS, GQA_GROUP, HEAD_DIM)

    def band(t):
        prev = jnp.pad(t, ((0, 0), (BLOCK, 0), (0, 0), (0, 0)))[:, :s]
        prev = prev.reshape(b, nb, BLOCK, KV_HEADS, HEAD_DIM)
        cur = t.reshape(b, nb, BLOCK, KV_HEADS, HEAD_DIM)
        return jnp.concatenate([prev, cur], axis=2)

    kb, vb = band(k), band(v)
    logits = jnp.einsum('bnqhgd,bnkhd->bnhgqk', qb, kb).astype(jnp.float32) * (HEAD_DIM ** -0.5)
    logits = jnp.where(mask[None, :, None, None], logits + bias, NEG_INF)
    sink = jnp.broadcast_to(sinks.astype(jnp.float32).reshape(KV_HEADS, GQA_GROUP, 1, 1),
                            logits.shape[:-1] + (1,))
    probs = jax.nn.softmax(jnp.concatenate([logits, sink], axis=-1), axis=-1)[..., :-1]
    out = jnp.einsum('bnhgqk,bnkhd->bnqhgd', probs.astype(vb.dtype), vb)
    return out.reshape(b, s, Q_COLS)


def conformer_conv_group(a, g, conv_w, conv_b, ln_g, ln_b):
    u = a * jax.nn.sigmoid(g)
    u = jnp.pad(u, ((0, 0), (CONV_WIDTH - 1, 0), (0, 0)))
    y = lax.conv_general_dilated(u, conv_w[:, None, :], window_strides=(1,), padding='VALID',
                                 dimension_numbers=('NWC', 'WIO', 'NWC'),
                                 feature_group_count=CONV_CH) + conv_b
    y = layer_norm(y, ln_g, ln_b)
    return y * jax.nn.sigmoid(y)


def hybrid_mixer(x, w_in, b_in, conv_w, conv_b, conv_ln_g, conv_ln_b, sinks, bias, mask, w_out, b_out):
    b, s, _ = x.shape
    proj = x @ w_in + b_in
    cuts = [CONV_CH, 2 * CONV_CH, 2 * CONV_CH + Q_COLS, 2 * CONV_CH + Q_COLS + KV_COLS]
    a, g, q, k, v = jnp.split(proj, cuts, axis=-1)
    conv_out = conformer_conv_group(a, g, conv_w, conv_b, conv_ln_g, conv_ln_b)
    attn_out = sliding_window_sink_attention(
        q.reshape(b, s, KV_HEADS, GQA_GROUP, HEAD_DIM),
        k.reshape(b, s, KV_HEADS, HEAD_DIM),
        v.reshape(b, s, KV_HEADS, HEAD_DIM), sinks, bias, mask)
    return jnp.concatenate([conv_out, attn_out], axis=-1) @ w_out + b_out


def memory_cross_attention(x, mem, wq, wkv, wo):
    b, s, _ = x.shape
    q = (x @ wq).reshape(b, s, X_HEADS, X_HEAD_DIM)
    k, v = jnp.split(mem @ wkv, 2, axis=-1)
    k = k.reshape(b, -1, X_HEADS, X_HEAD_DIM)
    v = v.reshape(b, -1, X_HEADS, X_HEAD_DIM)
    logits = jnp.einsum('bshd,bmhd->bhsm', q, k).astype(jnp.float32) * (X_HEAD_DIM ** -0.5)
    probs = jax.nn.softmax(logits, axis=-1).astype(v.dtype)
    out = jnp.einsum('bhsm,bmhd->bshd', probs, v).reshape(b, s, D_MODEL)
    return out @ wo


def route(xt, router_w, router_b):
    t = xt.shape[0]
    scores = jax.nn.sigmoid((xt @ router_w).astype(jnp.float32))
    choice = scores + router_b.astype(jnp.float32)
    grp = choice.reshape(t, N_GROUPS, N_EXPERTS // N_GROUPS)
    grp_score = jnp.sum(lax.top_k(grp, 2)[0], axis=-1)
    _, grp_idx = lax.top_k(grp_score, TOPK_GROUPS)
    grp_keep = jnp.any(grp_idx[:, :, None] == jnp.arange(N_GROUPS)[None, None, :], axis=1)
    keep = jnp.repeat(grp_keep, N_EXPERTS // N_GROUPS, axis=1)
    _, idx = lax.top_k(jnp.where(keep, choice, -jnp.inf), TOP_K)
    w = jnp.take_along_axis(scores, idx, axis=1)
    w = w / jnp.sum(w, axis=-1, keepdims=True) * ROUTED_SCALE
    return idx, w


def moe_ffn(h, router_w, router_b, exp_gate, exp_up, exp_down, sh_gate, sh_up, sh_down):
    b, s, d = h.shape
    xt = h.reshape(-1, d)
    t = xt.shape[0]
    idx, gate = route(xt, router_w, router_b)
    n_assign = t * TOP_K
    flat_e = idx.reshape(-1)
    flat_tok = jnp.repeat(jnp.arange(t, dtype=jnp.int32), TOP_K)
    flat_w = gate.reshape(-1)
    order = jnp.argsort(flat_e)
    e_s, tok_s, w_s = flat_e[order], flat_tok[order], flat_w[order]
    counts = jnp.bincount(flat_e, length=N_EXPERTS)
    seg_start = jnp.cumsum(counts) - counts
    pad_counts = (counts + EXPERT_BLOCK - 1) // EXPERT_BLOCK * EXPERT_BLOCK
    pad_end = jnp.cumsum(pad_counts)
    pad_start = pad_end - pad_counts
    dest = pad_start[e_s] + (jnp.arange(n_assign) - seg_start[e_s])
    n_blocks = -(-n_assign // EXPERT_BLOCK) + N_EXPERTS
    n_rows = n_blocks * EXPERT_BLOCK
    row_tok = jnp.full((n_rows,), t, jnp.int32).at[dest].set(tok_s)
    row_w = jnp.zeros((n_rows,), jnp.float32).at[dest].set(w_s)
    block_e = jnp.minimum(jnp.searchsorted(pad_end, jnp.arange(n_blocks) * EXPERT_BLOCK, side='right'),
                          N_EXPERTS - 1)
    x_pad = jnp.concatenate([xt, jnp.zeros((1, d), xt.dtype)], axis=0)
    xb = x_pad[row_tok].reshape(n_blocks, EXPERT_BLOCK, d)

    def expert_block(args):
        xblk, e = args
        return (jax.nn.silu(xblk @ exp_gate[e]) * (xblk @ exp_up[e])) @ exp_down[e]

    yb = lax.map(expert_block, (xb, block_e)).reshape(n_rows, d)
    routed = jax.ops.segment_sum(yb * row_w[:, None].astype(yb.dtype), row_tok, num_segments=t + 1)[:t]
    shared = (jax.nn.silu(xt @ sh_gate) * (xt @ sh_up)) @ sh_down
    return (routed + shared).reshape(b, s, d)


def setup_inputs(seed: int = 0) -> dict:
    key = jax.random.key(seed)
    ks = jax.random.split(key, 32)
    L, D = DEPTH, D_MODEL
    f32 = jnp.float32

    def nrm(k, shape, scale):
        return jax.random.normal(k, shape, f32) * scale

    def gain(k, shape):
        return 1.0 + 0.05 * jax.random.normal(k, shape, f32)

    return {
        'x': nrm(ks[0], (BATCH, SEQ, D), 1.0),
        'mem': nrm(ks[1], (BATCH, MEM_LEN, D), 1.0),
        'w_in': nrm(ks[2], (L, D, IN_COLS), D ** -0.5),
        'b_in': nrm(ks[3], (L, IN_COLS), 0.01),
        'conv_w': nrm(ks[4], (L, CONV_WIDTH, CONV_CH), CONV_WIDTH ** -0.5),
        'conv_b': nrm(ks[5], (L, CONV_CH), 0.01),
        'conv_ln_g': gain(ks[6], (L, CONV_CH)),
        'conv_ln_b': nrm(ks[7], (L, CONV_CH), 0.01),
        'attn_sinks': nrm(ks[8], (L, ATT_HEADS), 0.5),
        'rel_bias': nrm(ks[9], (REL_BUCKETS, ATT_HEADS), 0.5),
        'w_out': nrm(ks[10], (L, MIX_WIDTH, D), BETA * MIX_WIDTH ** -0.5),
        'b_out': nrm(ks[11], (L, D), 0.01),
        'ln1_g': gain(ks[12], (L, D)),
        'ln1_b': nrm(ks[13], (L, D), 0.01),
        'xq_w': nrm(ks[14], (L, D, D), D ** -0.5),
        'xkv_w': nrm(ks[15], (L, D, 2 * D), D ** -0.5),
        'xo_w': nrm(ks[16], (L, D, D), BETA * D ** -0.5),
        'ln2_g': gain(ks[17], (L, D)),
        'ln2_b': nrm(ks[18], (L, D), 0.01),
        'router_w': nrm(ks[19], (L, D, N_EXPERTS), D ** -0.5),
        'router_b': nrm(ks[20], (L, N_EXPERTS), 0.01),
        'exp_gate': nrm(ks[21], (L, N_EXPERTS, D, EXPERT_FF), D ** -0.5),
        'exp_up': nrm(ks[22], (L, N_EXPERTS, D, EXPERT_FF), D ** -0.5),
        'exp_down': nrm(ks[23], (L, N_EXPERTS, EXPERT_FF, D), BETA * EXPERT_FF ** -0.5),
        'sh_gate': nrm(ks[24], (L, D, SHARED_FF), D ** -0.5),
        'sh_up': nrm(ks[25], (L, D, SHARED_FF), D ** -0.5),
        'sh_down': nrm(ks[26], (L, SHARED_FF, D), BETA * SHARED_FF ** -0.5),
        'ln3_g': gain(ks[27], (L, D)),
        'ln3_b': nrm(ks[28], (L, D), 0.01),
    }


def reference(x, mem, w_in, b_in, conv_w, conv_b, conv_ln_g, conv_ln_b, attn_sinks, rel_bias,
              w_out, b_out, ln1_g, ln1_b, xq_w, xkv_w, xo_w, ln2_g, ln2_b, router_w, router_b,
              exp_gate, exp_up, exp_down, sh_gate, sh_up, sh_down, ln3_g, ln3_b):
    bias, mask = band_bias_and_mask(rel_bias, x.shape[1])
    for l in range(DEPTH):
        mix = hybrid_mixer(x, w_in[l], b_in[l], conv_w[l], conv_b[l], conv_ln_g[l], conv_ln_b[l],
                           attn_sinks[l], bias, mask, w_out[l], b_out[l])
        x = layer_norm(ALPHA * x + mix, ln1_g[l], ln1_b[l])
        cross = memory_cross_attention(x, mem, xq_w[l], xkv_w[l], xo_w[l])
        x = layer_norm(ALPHA * x + cross, ln2_g[l], ln2_b[l])
        ffn = moe_ffn(x, router_w[l], router_b[l], exp_gate[l], exp_up[l], exp_down[l],
                      sh_gate[l], sh_up[l], sh_down[l])
        x = layer_norm(ALPHA * x + ffn, ln3_g[l], ln3_b[l])
    return x
```

```cpp
#include <hip/hip_runtime.h>
#include <cstdint>
#include <cstdio>

namespace gold {
constexpr int D = 1024, BATCH = 4, SEQ = 4096, T = BATCH * SEQ, MEM = 256;
constexpr int CONV_CH = 512, CONV_W = 31, INC = 1792;
constexpr int NE = 64, TOPK = 8, EFF = 256, NASSIGN = T * TOPK;
constexpr float ALPHA = 1.189207115002721f, LN_EPS = 1e-5f;
constexpr int MAXTILES = NASSIGN / 64 + NE;

__device__ __forceinline__ float sigmoidf_(float x) { return 1.0f / (1.0f + expf(-x)); }

template <bool DUAL>
__device__ __forceinline__ void tile_core(const float* arow, const float* B1, const float* B2, int ldb, int n0, int K,
                                          float (&acc)[4][4], float (&acc2)[4][4]) {
    __shared__ float As[16][68];
    __shared__ float Bs[16][64];
    __shared__ float Bs2[DUAL ? 16 : 1][64];
    const int t = threadIdx.x, ty = t >> 4, tx = t & 15;
    const int lr = t >> 2, lk = (t & 3) * 4;
    const int bk = t >> 4, bn = (t & 15) * 4;
#pragma unroll
    for (int i = 0; i < 4; ++i)
#pragma unroll
        for (int j = 0; j < 4; ++j) { acc[i][j] = 0.f; acc2[i][j] = 0.f; }
    for (int k0 = 0; k0 < K; k0 += 16) {
        float4 av = arow ? *(const float4*)(arow + k0 + lk) : make_float4(0.f, 0.f, 0.f, 0.f);
        float4 bv = *(const float4*)(B1 + (size_t)(k0 + bk) * ldb + n0 + bn);
        float4 bv2 = make_float4(0.f, 0.f, 0.f, 0.f);
        if (DUAL) bv2 = *(const float4*)(B2 + (size_t)(k0 + bk) * ldb + n0 + bn);
        __syncthreads();
        As[lk + 0][lr] = av.x; As[lk + 1][lr] = av.y; As[lk + 2][lr] = av.z; As[lk + 3][lr] = av.w;
        *(float4*)&Bs[bk][bn] = bv;
        if (DUAL) *(float4*)&Bs2[bk][bn] = bv2;
        __syncthreads();
#pragma unroll
        for (int k = 0; k < 16; ++k) {
            const float4 a = *(const float4*)&As[k][ty * 4];
            const float4 b = *(const float4*)&Bs[k][tx * 4];
            const float aa[4] = {a.x, a.y, a.z, a.w}; const float bb[4] = {b.x, b.y, b.z, b.w};
#pragma unroll
            for (int i = 0; i < 4; ++i)
#pragma unroll
                for (int j = 0; j < 4; ++j) acc[i][j] += aa[i] * bb[j];
            if (DUAL) {
                const float4 b2 = *(const float4*)&Bs2[k][tx * 4];
                const float cc[4] = {b2.x, b2.y, b2.z, b2.w};
#pragma unroll
                for (int i = 0; i < 4; ++i)
#pragma unroll
                    for (int j = 0; j < 4; ++j) acc2[i][j] += aa[i] * cc[j];
            }
        }
    }
}

template <bool DUAL>
__global__ void __launch_bounds__(256) gemm_f32(const float* A, int lda, const float* B, const float* B2, int ldb, const float* bias,
                                                float* C, int ldc, int K) {
    const int n0 = blockIdx.x * 64, m0 = blockIdx.y * 64, t = threadIdx.x, ty = t >> 4, tx = t & 15;
    const float* arow = A + (size_t)(m0 + (t >> 2)) * lda;
    float acc[4][4], acc2[4][4];
    tile_core<DUAL>(arow, B, B2, ldb, n0, K, acc, acc2);
#pragma unroll
    for (int i = 0; i < 4; ++i) {
        float o[4];
#pragma unroll
        for (int j = 0; j < 4; ++j) {
            float v = acc[i][j];
            if (DUAL) { const float g = v; v = g * sigmoidf_(g) * acc2[i][j]; }
            if (bias) v += bias[n0 + tx * 4 + j];
            o[j] = v;
        }
        *(float4*)(C + (size_t)(m0 + ty * 4 + i) * ldc + n0 + tx * 4) = make_float4(o[0], o[1], o[2], o[3]);
    }
}

__device__ __forceinline__ float block_sum(float v, float* red) {
#pragma unroll
    for (int o = 32; o > 0; o >>= 1) v += __shfl_xor(v, o);
    const int w = threadIdx.x >> 6, nw = blockDim.x >> 6;
    __syncthreads();
    if ((threadIdx.x & 63) == 0) red[w] = v;
    __syncthreads();
    float s = 0.f;
    for (int i = 0; i < nw; ++i) s += red[i];
    return s;
}
__device__ __forceinline__ float block_max(float v, float* red) {
#pragma unroll
    for (int o = 32; o > 0; o >>= 1) v = fmaxf(v, __shfl_xor(v, o));
    const int w = threadIdx.x >> 6, nw = blockDim.x >> 6;
    __syncthreads();
    if ((threadIdx.x & 63) == 0) red[w] = v;
    __syncthreads();
    float s = red[0];
    for (int i = 1; i < nw; ++i) s = fmaxf(s, red[i]);
    return s;
}

__global__ void __launch_bounds__(512) conv_ln_kernel(const float* proj, const float* cw, const float* cb, const float* lg, const float* lb, float* mix) {
    __shared__ float red[8];
    const int t = blockIdx.x, c = threadIdx.x, pos = t % SEQ;
    float acc = cb[c];
    for (int j = 0; j < CONV_W; ++j) {
        const int s = pos - (CONV_W - 1) + j;
        if (s >= 0) {
            const float* r = proj + (size_t)(t - (CONV_W - 1) + j) * INC;
            acc += cw[j * CONV_CH + c] * r[c] * sigmoidf_(r[CONV_CH + c]);
        }
    }
    const float mu = block_sum(acc, red) * (1.0f / CONV_CH);
    const float d = acc - mu;
    const float var = block_sum(d * d, red) * (1.0f / CONV_CH);
    const float y = d * rsqrtf(var + LN_EPS) * lg[c] + lb[c];
    mix[(size_t)t * D + c] = y * sigmoidf_(y);
}

__device__ __forceinline__ int t5_bucket(int n) {
    if (n < 16) return n;
    int large = 16 + (int)(logf((float)n / 16.0f) / logf(8.0f) * 16.0f);
    return large < 31 ? large : 31;
}

__global__ void __launch_bounds__(128) swa_kernel(const float* proj, const float* sinks, const float* rel_bias, float* mix) {
    __shared__ float qs[64];
    __shared__ float ps[128];
    __shared__ float red[2];
    const int t = blockIdx.x, h = blockIdx.y, j = threadIdx.x, pos = t % SEQ, kvh = h >> 2;
    if (j < 64) qs[j] = proj[(size_t)t * INC + 1024 + h * 64 + j];
    __syncthreads();
    const bool valid = (pos - j) >= 0;
    float logit = -1e30f;
    if (valid) {
        const float* kr = proj + (size_t)(t - j) * INC + 1536 + kvh * 64;
        float dot = 0.f;
        for (int d = 0; d < 64; ++d) dot += qs[d] * kr[d];
        logit = dot * 0.125f + rel_bias[t5_bucket(j) * 8 + h];
    }
    const float sink = sinks[h];
    const float m = fmaxf(block_max(logit, red), sink);
    const float p = valid ? expf(logit - m) : 0.f;
    const float denom = block_sum(p, red) + expf(sink - m);
    ps[j] = p / denom;
    __syncthreads();
    if (j < 64) {
        float o = 0.f;
        const int jmax = pos < 127 ? pos : 127;
        for (int jj = 0; jj <= jmax; ++jj) o += ps[jj] * proj[(size_t)(t - jj) * INC + 1664 + kvh * 64 + j];
        mix[(size_t)t * D + 512 + h * 64 + j] = o;
    }
}

__global__ void __launch_bounds__(256) add_ln_kernel(const float* res, const float* add, const float* g, const float* b, float* out) {
    __shared__ float red[4];
    const size_t row = blockIdx.x;
    const int c = threadIdx.x * 4;
    const float4 r = *(const float4*)(res + row * D + c), a = *(const float4*)(add + row * D + c);
    float v[4] = {ALPHA * r.x + a.x, ALPHA * r.y + a.y, ALPHA * r.z + a.z, ALPHA * r.w + a.w};
    const float mu = block_sum(v[0] + v[1] + v[2] + v[3], red) * (1.0f / D);
    float q = 0.f;
#pragma unroll
    for (int i = 0; i < 4; ++i) { v[i] -= mu; q += v[i] * v[i]; }
    const float rstd = rsqrtf(block_sum(q, red) * (1.0f / D) + LN_EPS);
    const float4 gg = *(const float4*)(g + c), bb = *(const float4*)(b + c);
    *(float4*)(out + row * D + c) = make_float4(v[0] * rstd * gg.x + bb.x, v[1] * rstd * gg.y + bb.y, v[2] * rstd * gg.z + bb.z, v[3] * rstd * gg.w + bb.w);
}

__global__ void __launch_bounds__(256) xattn_kernel(const float* qx, const float* kv, float* ca) {
    __shared__ float qs[256];
    __shared__ float ps[256];
    __shared__ float red[4];
    const int t = blockIdx.x, h = blockIdx.y, m = threadIdx.x, b = t / SEQ;
    qs[m] = qx[(size_t)t * D + h * 256 + m];
    __syncthreads();
    const float* kr = kv + (size_t)(b * MEM + m) * 2048 + h * 256;
    float dot = 0.f;
    for (int d = 0; d < 256; d += 4) { const float4 k4 = *(const float4*)(kr + d); dot += qs[d] * k4.x + qs[d + 1] * k4.y + qs[d + 2] * k4.z + qs[d + 3] * k4.w; }
    const float logit = dot * 0.0625f;
    const float mx = block_max(logit, red);
    const float p = expf(logit - mx);
    const float denom = block_sum(p, red);
    ps[m] = p / denom;
    __syncthreads();
    float o = 0.f;
    const float* vb = kv + (size_t)(b * MEM) * 2048 + 1024 + h * 256 + m;
    for (int mm = 0; mm < MEM; ++mm) o += ps[mm] * vb[(size_t)mm * 2048];
    ca[(size_t)t * D + h * 256 + m] = o;
}

__global__ void __launch_bounds__(128) route_kernel(const float* logits, const float* rbias, int* idx_out, float* gate_out, int* cnt, int* pos_out) {
    __shared__ float ch[64][128];
    __shared__ float sc[64][128];
    const int tid = threadIdx.x, t = blockIdx.x * 128 + tid;
    for (int j = 0; j < 64; ++j) { const float s = sigmoidf_(logits[(size_t)t * 64 + j]); sc[j][tid] = s; ch[j][tid] = s + rbias[j]; }
    float gs[8];
#pragma unroll
    for (int g = 0; g < 8; ++g) {
        float m1 = -INFINITY, m2 = -INFINITY;
#pragma unroll
        for (int i = 0; i < 8; ++i) { const float v = ch[g * 8 + i][tid]; if (v > m1) { m2 = m1; m1 = v; } else if (v > m2) m2 = v; }
        gs[g] = m1 + m2;
    }
    unsigned keep = 0;
#pragma unroll
    for (int g = 0; g < 8; ++g) {
        int rank = 0;
#pragma unroll
        for (int g2 = 0; g2 < 8; ++g2) rank += (gs[g2] > gs[g] || (gs[g2] == gs[g] && g2 < g)) ? 1 : 0;
        if (rank < 4) keep |= 1u << g;
    }
    for (int j = 0; j < 64; ++j) if (!((keep >> (j >> 3)) & 1u)) ch[j][tid] = -INFINITY;
    int sel[8]; float w[8]; float wsum = 0.f;
#pragma unroll
    for (int k = 0; k < 8; ++k) {
        float best = -INFINITY; int bi = 0;
        for (int j = 0; j < 64; ++j) { const float v = ch[j][tid]; if (v > best) { best = v; bi = j; } }
        sel[k] = bi; w[k] = sc[bi][tid]; wsum += w[k]; ch[bi][tid] = -INFINITY;
    }
#pragma unroll
    for (int k = 0; k < 8; ++k) {
        idx_out[t * 8 + k] = sel[k];
        gate_out[t * 8 + k] = w[k] / wsum * 2.5f;
        pos_out[t * 8 + k] = atomicAdd(&cnt[sel[k]], 1);
    }
}
__global__ void prefix_kernel(const int* cnt, int* seg) { if (threadIdx.x == 0) { int s = 0; for (int e = 0; e < NE; ++e) { seg[e] = s; s += cnt[e]; } seg[NE] = s; } }
__global__ void scatter_kernel(const int* idx, const float* gate, const int* pos, const int* seg, int* row_tok, float* row_w) {
    const int a = blockIdx.x * 256 + threadIdx.x;
    if (a < NASSIGN) { const int r = seg[idx[a]] + pos[a]; row_tok[r] = a >> 3; row_w[r] = gate[a]; }
}

__device__ __forceinline__ bool moe_tile(const int* cnt, const int* seg, int tile, int& e, int& r0, int& nr) {
    int acc = 0;
    for (int i = 0; i < NE; ++i) {
        const int c = cnt[i], nt = (c + 63) >> 6;
        if (tile < acc + nt) { e = i; const int lt = tile - acc; r0 = seg[i] + lt * 64; nr = c - lt * 64; if (nr > 64) nr = 64; return true; }
        acc += nt;
    }
    return false;
}
__global__ void __launch_bounds__(256) moe_up_kernel(const float* x2, const float* Wg, const float* Wu, const int* cnt, const int* seg, const int* row_tok, float* H) {
    int e, r0, nr;
    if (!moe_tile(cnt, seg, blockIdx.x, e, r0, nr)) return;
    const int t = threadIdx.x, ty = t >> 4, tx = t & 15, n0 = blockIdx.y * 64;
    const int lr = t >> 2;
    const float* arow = (lr < nr) ? x2 + (size_t)row_tok[r0 + lr] * D : nullptr;
    float acc[4][4], acc2[4][4];
    tile_core<true>(arow, Wg + (size_t)e * D * EFF, Wu + (size_t)e * D * EFF, EFF, n0, D, acc, acc2);
#pragma unroll
    for (int i = 0; i < 4; ++i) {
        const int r = ty * 4 + i;
        if (r < nr) {
            float o[4];
#pragma unroll
            for (int j = 0; j < 4; ++j) { const float g = acc[i][j]; o[j] = g * sigmoidf_(g) * acc2[i][j]; }
            *(float4*)(H + (size_t)(r0 + r) * EFF + n0 + tx * 4) = make_float4(o[0], o[1], o[2], o[3]);
        }
    }
}
__global__ void __launch_bounds__(256) moe_down_kernel(const float* H, const float* Wd, const int* cnt, const int* seg, const int* row_tok, const float* row_w, float* outacc) {
    int e, r0, nr;
    if (!moe_tile(cnt, seg, blockIdx.x, e, r0, nr)) return;
    const int t = threadIdx.x, ty = t >> 4, tx = t & 15, n0 = blockIdx.y * 64;
    const int lr = t >> 2;
    const float* arow = (lr < nr) ? H + (size_t)(r0 + lr) * EFF : nullptr;
    float acc[4][4], acc2[4][4];
    tile_core<false>(arow, Wd + (size_t)e * EFF * D, nullptr, D, n0, EFF, acc, acc2);
#pragma unroll
    for (int i = 0; i < 4; ++i) {
        const int r = ty * 4 + i;
        if (r < nr) {
            const int tok = row_tok[r0 + r]; const float w = row_w[r0 + r];
#pragma unroll
            for (int j = 0; j < 4; ++j) atomicAdd(outacc + (size_t)tok * D + n0 + tx * 4 + j, w * acc[i][j]);
        }
    }
}
}

extern "C" void kernel_launch(void* const* d_in, const int* in_sizes, int n_in, void* d_out, int out_size, void* d_ws, size_t ws_size, hipStream_t stream) {
    using namespace gold;
    const float* x = (const float*)d_in[0];        const float* mem = (const float*)d_in[1];
    const float* w_in = (const float*)d_in[2];     const float* b_in = (const float*)d_in[3];
    const float* conv_w = (const float*)d_in[4];   const float* conv_b = (const float*)d_in[5];
    const float* cln_g = (const float*)d_in[6];    const float* cln_b = (const float*)d_in[7];
    const float* sinks = (const float*)d_in[8];    const float* rel_bias = (const float*)d_in[9];
    const float* w_out = (const float*)d_in[10];   const float* b_out = (const float*)d_in[11];
    const float* ln1_g = (const float*)d_in[12];   const float* ln1_b = (const float*)d_in[13];
    const float* xq_w = (const float*)d_in[14];    const float* xkv_w = (const float*)d_in[15];
    const float* xo_w = (const float*)d_in[16];    const float* ln2_g = (const float*)d_in[17];
    const float* ln2_b = (const float*)d_in[18];   const float* router_w = (const float*)d_in[19];
    const float* router_b = (const float*)d_in[20]; const float* exp_gate = (const float*)d_in[21];
    const float* exp_up = (const float*)d_in[22];  const float* exp_down = (const float*)d_in[23];
    const float* sh_gate = (const float*)d_in[24]; const float* sh_up = (const float*)d_in[25];
    const float* sh_down = (const float*)d_in[26]; const float* ln3_g = (const float*)d_in[27];
    const float* ln3_b = (const float*)d_in[28];
    float* out = (float*)d_out;
    char* ws = (char*)d_ws;
    const size_t SLOT = (size_t)T * D * 4;
    float* S0 = (float*)(ws); float* S1 = (float*)(ws + SLOT); float* S2 = (float*)(ws + 2 * SLOT); float* S3 = (float*)(ws + 3 * SLOT);
    char* sm = ws + 4 * SLOT;
    float* kvx = (float*)sm;                       sm += (size_t)BATCH * MEM * 2048 * 4;
    float* logits = (float*)sm;                    sm += (size_t)T * 64 * 4;
    int* idx = (int*)sm;                           sm += (size_t)NASSIGN * 4;
    float* gate = (float*)sm;                      sm += (size_t)NASSIGN * 4;
    int* pos = (int*)sm;                           sm += (size_t)NASSIGN * 4;
    int* row_tok = (int*)sm;                       sm += (size_t)NASSIGN * 4;
    float* row_w = (float*)sm;                     sm += (size_t)NASSIGN * 4;
    int* cnt = (int*)sm;                           sm += 256;
    int* seg = (int*)sm;                           sm += 512;
    float* hs = (float*)sm;                        sm += (size_t)T * EFF * 4;
    if ((size_t)(sm - ws) > ws_size) { fprintf(stderr, "ws too small: need %zu have %zu\n", (size_t)(sm - ws), ws_size); return; }

    float* proj = S0;
    float* mix = S2;
    gemm_f32<false><<<dim3(INC / 64, T / 64), 256, 0, stream>>>(x, D, w_in, nullptr, INC, b_in, proj, INC, D);
    conv_ln_kernel<<<T, 512, 0, stream>>>(proj, conv_w, conv_b, cln_g, cln_b, mix);
    swa_kernel<<<dim3(T, 8), 128, 0, stream>>>(proj, sinks, rel_bias, mix);
    gemm_f32<false><<<dim3(D / 64, T / 64), 256, 0, stream>>>(mix, D, w_out, nullptr, D, b_out, S3, D, D);
    add_ln_kernel<<<T, 256, 0, stream>>>(x, S3, ln1_g, ln1_b, S3);
    gemm_f32<false><<<dim3(D / 64, T / 64), 256, 0, stream>>>(S3, D, xq_w, nullptr, D, nullptr, S0, D, D);
    gemm_f32<false><<<dim3(2048 / 64, BATCH * MEM / 64), 256, 0, stream>>>(mem, D, xkv_w, nullptr, 2048, nullptr, kvx, 2048, D);
    xattn_kernel<<<dim3(T, 4), 256, 0, stream>>>(S0, kvx, S1);
    gemm_f32<false><<<dim3(D / 64, T / 64), 256, 0, stream>>>(S1, D, xo_w, nullptr, D, nullptr, S2, D, D);
    add_ln_kernel<<<T, 256, 0, stream>>>(S3, S2, ln2_g, ln2_b, S2);
    gemm_f32<false><<<dim3(1, T / 64), 256, 0, stream>>>(S2, D, router_w, nullptr, 64, nullptr, logits, 64, D);
    hipMemsetAsync(cnt, 0, 256, stream);
    route_kernel<<<T / 128, 128, 0, stream>>>(logits, router_b, idx, gate, cnt, pos);
    prefix_kernel<<<1, 64, 0, stream>>>(cnt, seg);
    scatter_kernel<<<NASSIGN / 256, 256, 0, stream>>>(idx, gate, pos, seg, row_tok, row_w);
    gemm_f32<true><<<dim3(EFF / 64, T / 64), 256, 0, stream>>>(S2, D, sh_gate, sh_up, EFF, nullptr, hs, EFF, D);
    gemm_f32<false><<<dim3(D / 64, T / 64), 256, 0, stream>>>(hs, EFF, sh_down, nullptr, D, nullptr, S3, D, EFF);
    moe_up_kernel<<<dim3(MAXTILES, EFF / 64), 256, 0, stream>>>(S2, exp_gate, exp_up, cnt, seg, row_tok, S0);
    moe_down_kernel<<<dim3(MAXTILES, D / 64), 256, 0, stream>>>(S0, exp_down, cnt, seg, row_tok, row_w, S3);
    add_ln_kernel<<<T, 256, 0, stream>>>(S2, S3, ln3_g, ln3_b, out);
}
```
